# Optimizing an MI355X kernel written in HIP

```python
import jax, jax.numpy as jnp
from jax import lax
import numpy as np

D_MODEL = 2048
BATCH = 4
SEQ = 4096
DEPTH = 2

N_A_LAYERS = DEPTH // 2
N_B_LAYERS = DEPTH - N_A_LAYERS
POOL_WINDOWS = (2, 4, 8, 16)
N_POOL_GROUPS = len(POOL_WINDOWS)
POOL_GROUP_DIM = D_MODEL // N_POOL_GROUPS
HEAD_DIM = 64
N_Q_HEADS = D_MODEL // HEAD_DIM
N_KV_HEADS = N_Q_HEADS // 8
GQA_GROUP = N_Q_HEADS // N_KV_HEADS
ATTN_WIDTH = N_Q_HEADS * HEAD_DIM
KV_WIDTH = N_KV_HEADS * HEAD_DIM
WINDOW = 128
BLOCK = 128
ROPE_THETA = 10000.0
LN_EPS = 1e-5
NEG_INF = -1e30
DEEPNORM_ALPHA = (2 * DEPTH) ** 0.25
DEEPNORM_BETA = (8 * DEPTH) ** -0.25

kernel_name = "yoco_pool_swa_sink_hybrid"


def layer_norm(x, g, b):
    xf = x.astype(jnp.float32)
    mu = jnp.mean(xf, axis=-1, keepdims=True)
    var = jnp.mean(jnp.square(xf - mu), axis=-1, keepdims=True)
    y = (xf - mu) * lax.rsqrt(var + LN_EPS) * g.astype(jnp.float32) + b.astype(jnp.float32)
    return y.astype(x.dtype)


def rope(t, pos):
    d = t.shape[-1]
    inv_freq = ROPE_THETA ** (-jnp.arange(0, d, 2, dtype=jnp.float32) / d)
    ang = pos[:, None] * inv_freq[None, :]
    ang = jnp.concatenate([ang, ang], axis=-1)[:, None, :]
    tf = t.astype(jnp.float32)
    t1, t2 = tf[..., : d // 2], tf[..., d // 2:]
    rot = jnp.concatenate([-t2, t1], axis=-1)
    return (tf * jnp.cos(ang) + rot * jnp.sin(ang)).astype(t.dtype)


def causal_window_mean(u, w):
    s = u.shape[1]
    c = jnp.cumsum(u, axis=1)
    c_prev = jnp.pad(c, ((0, 0), (w, 0), (0, 0)))[:, :s]
    count = jnp.minimum(jnp.arange(s) + 1, w).astype(jnp.float32)
    return (c - c_prev) / count[None, :, None]


def pool_mixer(x, w_in, w_group, scale, w_out):
    b, s, _ = x.shape
    h = x @ w_in
    u, z = h[..., :D_MODEL], h[..., D_MODEL:]
    ug = u.astype(jnp.float32).reshape(b, s, N_POOL_GROUPS, POOL_GROUP_DIM)
    pooled = jnp.stack(
        [causal_window_mean(ug[:, :, g], w) - ug[:, :, g] for g, w in enumerate(POOL_WINDOWS)],
        axis=2)
    mixed = jnp.einsum('bsgc,gcd->bsgd', pooled.astype(x.dtype), w_group).reshape(b, s, D_MODEL)
    y = mixed * scale * jax.nn.silu(z)
    return y @ w_out


def shared_kv(x, w_k, w_v, pos):
    b, s, _ = x.shape
    k = rope((x @ w_k).reshape(b, s, N_KV_HEADS, HEAD_DIM), pos)
    v = (x @ w_v).reshape(b, s, N_KV_HEADS, HEAD_DIM)
    return k, v


def band(t, nb):
    b = t.shape[0]
    tp = jnp.pad(t, ((0, 0), (BLOCK, 0), (0, 0), (0, 0)))
    tb = tp.reshape(b, nb + 1, BLOCK, t.shape[2], t.shape[3])
    return jnp.concatenate([tb[:, :-1], tb[:, 1:]], axis=2)


def banded_swa_with_sinks(q, k, v, sinks):
    b, s, _, d = q.shape
    nb = s // BLOCK
    qb = q.reshape(b, nb, BLOCK, N_KV_HEADS, GQA_GROUP, d)
    kb, vb = band(k, nb), band(v, nb)
    scores = jnp.einsum('bnqkgd,bnskd->bnkgqs', qb, kb,
                        preferred_element_type=jnp.float32) * (d ** -0.5)
    blk = jnp.arange(nb)[:, None, None]
    q_pos = blk * BLOCK + jnp.arange(BLOCK)[None, :, None]
    k_pos = (blk - 1) * BLOCK + jnp.arange(2 * BLOCK)[None, None, :]
    valid = (k_pos <= q_pos) & (k_pos > q_pos - WINDOW) & (k_pos >= 0)
    scores = jnp.where(valid[None, :, None, None], scores, NEG_INF)
    sink = sinks.astype(jnp.float32).reshape(N_KV_HEADS, GQA_GROUP)[None, None, :, :, None, None]
    m = jnp.maximum(jnp.max(scores, axis=-1, keepdims=True), sink)
    p = jnp.exp(scores - m)
    probs = p / (jnp.sum(p, axis=-1, keepdims=True) + jnp.exp(sink - m))
    out = jnp.einsum('bnkgqs,bnskd->bnqkgd', probs.astype(v.dtype), vb)
    return out.reshape(b, s, N_Q_HEADS * d)


def swa_mixer(x, k, v, w_qg, sinks, w_out, pos):
    b, s, _ = x.shape
    h = x @ w_qg
    q = rope(h[..., :ATTN_WIDTH].reshape(b, s, N_Q_HEADS, HEAD_DIM), pos)
    z = h[..., ATTN_WIDTH:]
    o = banded_swa_with_sinks(q, k, v, sinks)
    return (o * jax.nn.silu(z)) @ w_out


def setup_inputs(seed: int = 0) -> dict:
    key = jax.random.key(seed)
    ks = jax.random.split(key, 16)
    f32 = jnp.float32
    nrm = lambda k, shape, fan_in: jax.random.normal(k, shape, f32) * fan_in ** -0.5
    return {
        "x": jax.random.normal(ks[0], (BATCH, SEQ, D_MODEL), f32),
        "ln_g": 1.0 + 0.02 * jax.random.normal(ks[1], (DEPTH, D_MODEL), f32),
        "ln_b": 0.02 * jax.random.normal(ks[2], (DEPTH, D_MODEL), f32),
        "a_w_in": nrm(ks[3], (N_A_LAYERS, D_MODEL, 2 * D_MODEL), D_MODEL),
        "a_w_group": nrm(ks[4], (N_A_LAYERS, N_POOL_GROUPS, POOL_GROUP_DIM, POOL_GROUP_DIM), POOL_GROUP_DIM),
        "a_scale": 1.0 + 0.02 * jax.random.normal(ks[5], (N_A_LAYERS, D_MODEL), f32),
        "a_w_out": nrm(ks[6], (N_A_LAYERS, D_MODEL, D_MODEL), D_MODEL) * DEEPNORM_BETA,
        "b_w_k": nrm(ks[7], (D_MODEL, KV_WIDTH), D_MODEL),
        "b_w_v": nrm(ks[8], (D_MODEL, KV_WIDTH), D_MODEL) * DEEPNORM_BETA,
        "b_w_qg": nrm(ks[9], (N_B_LAYERS, D_MODEL, 2 * ATTN_WIDTH), D_MODEL),
        "b_sinks": 0.5 * jax.random.normal(ks[10], (N_B_LAYERS, N_Q_HEADS), f32),
        "b_w_out": nrm(ks[11], (N_B_LAYERS, ATTN_WIDTH, D_MODEL), ATTN_WIDTH) * DEEPNORM_BETA,
    }


def reference(x, ln_g, ln_b, a_w_in, a_w_group, a_scale, a_w_out,
              b_w_k, b_w_v, b_w_qg, b_sinks, b_w_out):
    s = x.shape[1]
    pos = jnp.arange(s, dtype=jnp.float32)
    k_sh, v_sh = None, None
    for i in range(DEPTH):
        if i < N_A_LAYERS:
            y = pool_mixer(x, a_w_in[i], a_w_group[i], a_scale[i], a_w_out[i])
        else:
            j = i - N_A_LAYERS
            if j == 0:
                k_sh, v_sh = shared_kv(x, b_w_k, b_w_v, pos)
            y = swa_mixer(x, k_sh, v_sh, b_w_qg[j], b_sinks[j], b_w_out[j], pos)
        x = layer_norm(DEEPNORM_ALPHA * x + y, ln_g[i], ln_b[i])
    return x
```

```cpp
#include <hip/hip_runtime.h>
#include <hip/hip_cooperative_groups.h>
#include <cstdio>
#include <cstdint>
#include <cmath>
namespace cg = cooperative_groups;

#define LAS __attribute__((address_space(3)))
typedef unsigned short bf16_t;
typedef short bf16x8 __attribute__((ext_vector_type(8)));
typedef short s16x4 __attribute__((ext_vector_type(4)));
typedef float f32x4 __attribute__((ext_vector_type(4)));
typedef float f32x2 __attribute__((ext_vector_type(2)));
typedef float f32x16 __attribute__((ext_vector_type(16)));
typedef unsigned u32x4 __attribute__((ext_vector_type(4)));
typedef unsigned u32x2 __attribute__((ext_vector_type(2)));
typedef __bf16 bf16x2_t __attribute__((ext_vector_type(2)));

constexpr int DM = 2048, SEQ = 4096, MTOK = 16384, NQ = 32, HD = 64;
constexpr int NH1 = 4096;
constexpr int NQZKV = 4608;
constexpr float LN_EPS = 1e-5f;
constexpr float ALPHA = 1.41421356237309515f;
constexpr float LOG2E = 1.4426950408889634f;

constexpr size_t MiB = 1u << 20;
constexpr size_t WS_XB = 0, WS_W1T = 64 * MiB, WS_WINU = 80 * MiB, WS_WGT = 88 * MiB, WS_W2T = 90 * MiB, WS_W3T = 98 * MiB, WS_W4T = 116 * MiB,
                 WS_ROPE = 124 * MiB, WS_H = 128 * MiB, WS_Y = 272 * MiB, WS_R = 336 * MiB, WS_END = 464 * MiB;

constexpr int NWAVES = 8, NTHREADS = 512;
constexpr int LDS_BYTES = 131072 + 1024;

__device__ __forceinline__ unsigned cvtpk(float lo, float hi) { f32x2 v = {lo, hi}; bf16x2_t b = __builtin_convertvector(v, bf16x2_t); return __builtin_bit_cast(unsigned, b); }
__device__ __forceinline__ float bf_lo(unsigned w) { return __uint_as_float(w << 16); }
__device__ __forceinline__ float bf_hi(unsigned w) { return __uint_as_float(w & 0xffff0000u); }
__device__ __forceinline__ float silu_f(float z) { return z * __builtin_amdgcn_rcpf(1.0f + __builtin_amdgcn_exp2f(-z * LOG2E)); }

namespace pg8 {
constexpr int BM = 256, BK = 64, HALF = 128, HTB = HALF * BK * 2, STAGE_BYTES = 8 * HTB, NXCD = 8, WGM = 8;
__host__ __device__ __forceinline__ int lds_byte(int r, int c) { const int st = (r >> 4) * 2 + (c >> 5), rr = r & 15, cc = c & 31, ob = rr * 64 + cc * 2; return st * 1024 + (ob ^ (((ob >> 9) & 1) << 5)); }
__host__ __device__ __forceinline__ void stage_rc(int b, int& R, int& C) { const int st = b / 1024, sb = b % 1024, swz = sb ^ (((sb >> 9) & 1) << 5); R = (st >> 1) * 16 + swz / 64; C = (st & 1) * 32 + (swz % 64) / 2; }
__host__ __device__ __forceinline__ int perm32(int rho) { const int n = rho >> 4, i = rho & 15; return 8 * (i >> 2) + 4 * n + (i & 3); }

struct Unit { int pm, pn; };
struct Gemm { const bf16_t* A; const bf16_t* Bt; int M, N, K, lda, ldb; int bsh; int bgo; };

struct StaticOrder {
    int nM, nN, nwg, G, c;
    __host__ __device__ void init(int M, int N, int G_, int c_) { nM = M / BM; nN = N / BM; nwg = nM * nN; G = G_; c = c_; }
    __host__ __device__ bool next(int i, Unit& u) const {
        const long L = (long)i * G + c; if (L >= nwg) return false;
        int wgid = (int)L; { const int q = nwg / NXCD, r = nwg % NXCD, xcd = wgid % NXCD, off = wgid / NXCD; wgid = (xcd < r ? xcd * (q + 1) : r * (q + 1) + (xcd - r) * q) + off; }
        const int nig = WGM * nN, gid = wgid / nig, fm = gid * WGM, gsz = (nM - fm) < WGM ? (nM - fm) : WGM;
        u.pm = fm + ((wgid % nig) % gsz); u.pn = (wgid % nig) / gsz; return true;
    }
};


struct EpiBf16 {
    bf16_t* O; int ldc;
    __device__ __forceinline__ void operator()(const f32x4 (&acc)[2][2][4][2], const Unit& u, int wr, int wc, int fr, int fq) const {
        const int row0 = u.pm * BM + wr * 64 + fr, col0 = u.pn * BM + wc * 32 + 8 * fq;
#pragma unroll
        for (int ai = 0; ai < 2; ++ai)
#pragma unroll
            for (int m = 0; m < 4; ++m) { bf16_t* rowp = O + (size_t)(row0 + ai * HALF + m * 16) * ldc + col0;
#pragma unroll
                for (int bj = 0; bj < 2; ++bj) { const f32x4 v0 = acc[ai][bj][m][0], v1 = acc[ai][bj][m][1];
                    u32x4 w; w.x = cvtpk(v0[0], v0[1]); w.y = cvtpk(v0[2], v0[3]); w.z = cvtpk(v1[0], v1[1]); w.w = cvtpk(v1[2], v1[3]);
                    *(u32x4*)(rowp + bj * HALF) = w; } }
    }
};
struct EpiRes {
    const float* res; float* out; int ldc;
    __device__ __forceinline__ void operator()(const f32x4 (&acc)[2][2][4][2], const Unit& u, int wr, int wc, int fr, int fq) const {
        const int row0 = u.pm * BM + wr * 64 + fr, col0 = u.pn * BM + wc * 32 + 8 * fq;
#pragma unroll
        for (int ai = 0; ai < 2; ++ai)
#pragma unroll
            for (int m = 0; m < 4; ++m) { const size_t off = (size_t)(row0 + ai * HALF + m * 16) * ldc + col0;
#pragma unroll
                for (int bj = 0; bj < 2; ++bj) {
                    const f32x4 r0 = *(const f32x4*)(res + off + bj * HALF), r1 = *(const f32x4*)(res + off + bj * HALF + 4);
                    *(f32x4*)(out + off + bj * HALF) = r0 * ALPHA + acc[ai][bj][m][0];
                    *(f32x4*)(out + off + bj * HALF + 4) = r1 * ALPHA + acc[ai][bj][m][1]; } }
    }
};
struct EpiQKV {
    bf16_t* O; const float* rope;
    __device__ __forceinline__ void operator()(const f32x4 (&acc)[2][2][4][2], const Unit& u, int wr, int wc, int fr, int fq) const {
        const int row0 = u.pm * BM + wr * 64 + fr, col0 = u.pn * BM + wc * 32 + 8 * fq;
        const bool isq = u.pn < 8, isk = u.pn == 16;
        const float sc = isq ? 0.125f * LOG2E : 1.0f;
        const int i0 = (wc & 1) * 16 + 4 * fq;
#pragma unroll
        for (int ai = 0; ai < 2; ++ai)
#pragma unroll
            for (int m = 0; m < 4; ++m) { const int row = row0 + ai * HALF + m * 16; bf16_t* rowp = O + (size_t)row * NQZKV + col0;
                f32x4 t0 = {1.f, 0.f, 1.f, 0.f}, t1 = {1.f, 0.f, 1.f, 0.f};
                if (isq || isk) { const float* tp = rope + ((size_t)(row & (SEQ - 1)) * 32 + i0) * 2; t0 = *(const f32x4*)tp; t1 = *(const f32x4*)(tp + 4); }
#pragma unroll
                for (int bj = 0; bj < 2; ++bj) { const f32x4 v0 = acc[ai][bj][m][0] * sc, v1 = acc[ai][bj][m][1] * sc;
                    u32x4 w;
                    w.x = cvtpk(v0[0] * t0[0] - v0[1] * t0[1], v0[1] * t0[0] + v0[0] * t0[1]);
                    w.y = cvtpk(v0[2] * t0[2] - v0[3] * t0[3], v0[3] * t0[2] + v0[2] * t0[3]);
                    w.z = cvtpk(v1[0] * t1[0] - v1[1] * t1[1], v1[1] * t1[0] + v1[0] * t1[1]);
                    w.w = cvtpk(v1[2] * t1[2] - v1[3] * t1[3], v1[3] * t1[2] + v1[2] * t1[3]);
                    *(u32x4*)(rowp + bj * HALF) = w; } }
    }
};

template <class Epi, class Sched, bool ALIGN_EPI>
__device__ __forceinline__ void gemm_phase(LAS unsigned char* lds, const Gemm g, const Sched& S, const Epi& E) {
    const int tid = threadIdx.x, wid = __builtin_amdgcn_readfirstlane(tid >> 6), lane = tid & 63, wr = wid >> 2, wc = wid & 3, fr = lane & 15, fq = lane >> 4;
    const int K = g.K, nt = K / BK;
    unsigned voffA[2], voffB[2];
#pragma unroll
    for (int i = 0; i < 2; ++i) { int R, C; stage_rc(tid * 16 + i * 8192, R, C); const int Rb = (R & ~31) + perm32(R & 31);
        voffA[i] = (unsigned)(R * g.lda + C) * 2u; voffB[i] = (unsigned)(Rb * g.ldb + C) * 2u; }
    const size_t kstep = (size_t)(BK * 2);
    const size_t hstepA = (size_t)HALF * g.lda * 2, hstepB = (size_t)HALF * g.ldb * 2;
    const size_t tstepA = 2 * hstepA, tstepB = 2 * hstepB;
    const unsigned ldsw = (unsigned)wid * 1024u;
    const int aoff = lds_byte(wr * 64 + fr, fq * 8), boff = lds_byte(wc * 32 + fr, fq * 8);
#define PG8_SA(b, h) (((b) * 2 + (h)) * HTB)
#define PG8_SB(b, h) ((4 + (b) * 2 + (h)) * HTB)
#define PG8_STAGE(bufoff, gbase, voff) do { _Pragma("unroll") for (int _i = 0; _i < 2; ++_i) \
        __builtin_amdgcn_global_load_lds((const unsigned*)((const char*)(gbase) + (voff)[_i]), (LAS unsigned*)(lds + (bufoff) + ldsw + _i * 8192), 16, 0, 0); } while (0)
#define PG8_LDA(dst, b, h) do { _Pragma("unroll") for (int m = 0; m < 4; ++m) _Pragma("unroll") for (int k = 0; k < 2; ++k) dst[m][k] = *(const LAS bf16x8*)(lds + PG8_SA(b, h) + aoff + m * 2048 + k * 1024); } while (0)
#define PG8_LDB(dst, b, h) do { _Pragma("unroll") for (int n = 0; n < 2; ++n) _Pragma("unroll") for (int k = 0; k < 2; ++k) dst[n][k] = *(const LAS bf16x8*)(lds + PG8_SB(b, h) + boff + n * 2048 + k * 1024); } while (0)
#define PG8_MMA(ai, bj, At, Bt) do { __builtin_amdgcn_s_setprio(1); _Pragma("unroll") for (int m = 0; m < 4; ++m) _Pragma("unroll") for (int n = 0; n < 2; ++n) _Pragma("unroll") for (int k = 0; k < 2; ++k) \
        acc[ai][bj][m][n] = __builtin_amdgcn_mfma_f32_16x16x32_bf16(Bt[n][k], At[m][k], acc[ai][bj][m][n], 0, 0, 0); __builtin_amdgcn_s_setprio(0); } while (0)
#define PG8_WAIT_V(n) asm volatile("s_waitcnt vmcnt(" #n ")" ::: "memory")
#define PG8_WAIT_L(n) asm volatile("s_waitcnt lgkmcnt(" #n ")" ::: "memory")
#define PG8_BAR __builtin_amdgcn_s_barrier()
#define PG8_SCHED __builtin_amdgcn_sched_barrier(0)
    Unit cur, nxt; int ui = 0;
    if (!S.next(0, cur)) return;
    f32x4 acc[2][2][4][2];
#pragma unroll
    for (int a = 0; a < 2; ++a)
#pragma unroll
        for (int b = 0; b < 2; ++b)
#pragma unroll
            for (int m = 0; m < 4; ++m)
#pragma unroll
                for (int n = 0; n < 2; ++n) acc[a][b][m][n] = (f32x4){0.f, 0.f, 0.f, 0.f};
    bf16x8 At[4][2], B0[2][2], B1[2][2];
    const char* cA = (const char*)g.A + (size_t)cur.pm * tstepA; const char* cB = (const char*)g.Bt + (size_t)cur.pn * tstepB + (size_t)(cur.pm >> g.bsh) * g.bgo;
    PG8_STAGE(PG8_SB(0, 0), cB, voffB); PG8_STAGE(PG8_SB(0, 1), cB + hstepB, voffB); PG8_STAGE(PG8_SA(0, 0), cA, voffA); PG8_STAGE(PG8_SA(0, 1), cA + hstepA, voffA);
    if (wr == 1) PG8_BAR;
    PG8_WAIT_V(2); PG8_BAR;
    PG8_STAGE(PG8_SB(1, 0), cB + kstep, voffB); PG8_STAGE(PG8_SA(1, 0), cA + kstep, voffA); PG8_STAGE(PG8_SB(1, 1), cB + hstepB + kstep, voffB);
    PG8_WAIT_V(6); PG8_BAR;
    for (;;) {
        const bool has_next = S.next(ui + 1, nxt);
        const char* nA = has_next ? (const char*)g.A + (size_t)nxt.pm * tstepA : cA;
        const char* nB = has_next ? (const char*)g.Bt + (size_t)nxt.pn * tstepB + (size_t)(nxt.pm >> g.bsh) * g.bgo : cB;
        for (int t = 0; t < nt; t += 2) {
            const bool last = (t == nt - 2);
            const char* a1 = cA + (size_t)(t + 1) * kstep;
            const char* a2 = last ? nA : cA + (size_t)(t + 2) * kstep; const char* b2 = last ? nB : cB + (size_t)(t + 2) * kstep;
            const char* a3 = a2 + kstep; const char* b3 = b2 + kstep;
            PG8_LDB(B0, 0, 0); PG8_LDB(B1, 0, 1); PG8_SCHED; PG8_LDA(At, 0, 0); PG8_STAGE(PG8_SA(1, 1), a1 + hstepA, voffA);
            PG8_WAIT_V(8); PG8_WAIT_L(0); PG8_BAR; PG8_MMA(0, 0, At, B0); PG8_MMA(0, 1, At, B1); PG8_BAR; PG8_SCHED;
            PG8_LDA(At, 0, 1); PG8_STAGE(PG8_SB(0, 0), b2, voffB); PG8_STAGE(PG8_SB(0, 1), b2 + hstepB, voffB); PG8_STAGE(PG8_SA(0, 0), a2, voffA);
            PG8_WAIT_V(8); PG8_WAIT_L(0); PG8_BAR; PG8_MMA(1, 0, At, B0); PG8_MMA(1, 1, At, B1); PG8_BAR; PG8_SCHED;
            PG8_LDB(B0, 1, 0); PG8_LDB(B1, 1, 1); PG8_SCHED; PG8_LDA(At, 1, 0); PG8_STAGE(PG8_SA(0, 1), a2 + hstepA, voffA);
            PG8_WAIT_V(8); PG8_WAIT_L(0); PG8_BAR; PG8_MMA(0, 0, At, B0); PG8_MMA(0, 1, At, B1); PG8_BAR; PG8_SCHED;
            PG8_LDA(At, 1, 1); PG8_STAGE(PG8_SB(1, 0), b3, voffB); PG8_STAGE(PG8_SB(1, 1), b3 + hstepB, voffB); PG8_STAGE(PG8_SA(1, 0), a3, voffA);
            PG8_WAIT_V(8); PG8_WAIT_L(0); PG8_BAR; PG8_MMA(1, 0, At, B0); PG8_MMA(1, 1, At, B1); PG8_BAR; PG8_SCHED;
        }
        if constexpr (ALIGN_EPI) { if (wr == 0) PG8_BAR; }
        E(acc, cur, wr, wc, fr, fq);
        if (!has_next) break;
#pragma unroll
        for (int a = 0; a < 2; ++a)
#pragma unroll
            for (int b = 0; b < 2; ++b)
#pragma unroll
                for (int m = 0; m < 4; ++m)
#pragma unroll
                    for (int n = 0; n < 2; ++n) acc[a][b][m][n] = (f32x4){0.f, 0.f, 0.f, 0.f};
        cur = nxt; cA = nA; cB = nB; ++ui;
        if constexpr (ALIGN_EPI) { if (wr == 1) PG8_BAR; }
    }
    PG8_WAIT_V(0);
    if constexpr (!ALIGN_EPI) { if (wr == 0) PG8_BAR; }
    PG8_BAR;
#undef PG8_SA
#undef PG8_SB
#undef PG8_STAGE
#undef PG8_LDA
#undef PG8_LDB
#undef PG8_MMA
#undef PG8_WAIT_V
#undef PG8_WAIT_L
#undef PG8_BAR
#undef PG8_SCHED
}
}

struct Args {
    const float* x; const float* ln_g; const float* ln_b; const float* a_w_in; const float* a_w_group; const float* a_scale; const float* a_w_out;
    const float* b_w_k; const float* b_w_v; const float* b_w_qg; const float* b_sinks; const float* b_w_out;
    float* out; unsigned char* ws;
};
__device__ const float INV_FREQ[32] = {1.0f, 0.7498942017555237f, 0.5623413324356079f, 0.4216965138912201f, 0.3162277638912201f, 0.23713737726211548f, 0.17782793939113617f, 0.1333521455526352f,
    0.10000000149011612f, 0.0749894231557846f, 0.05623413249850273f, 0.04216964915394783f, 0.03162277489900589f, 0.023713737726211548f, 0.017782794311642647f, 0.013335213996469975f,
    0.009999999776482582f, 0.007498942315578461f, 0.005623413249850273f, 0.0042169648222625256f, 0.003162277629598975f, 0.0023713738191872835f, 0.0017782794311642647f, 0.0013335214462131262f,
    0.0010000000474974513f, 0.0007498941849917173f, 0.000562341301701963f, 0.0004216965171508491f, 0.0003162277571391314f, 0.00023713737027719617f, 0.00017782794020604342f, 0.0001333521504420787f};

__device__ __forceinline__ float wave_sum(float v) {
#pragma unroll
    for (int o = 1; o < 64; o <<= 1) v += __shfl_xor(v, o);
    return v;
}

template <int MODE>
__device__ __forceinline__ void transpose_item(const float* W, int ldw, int col0, int K, int N, bf16_t* WT, int row_off, LAS float* scr, int item, int lane) {
    const int nblk = N / 32, kb = item / nblk, nb = item % nblk, k0 = 64 * kb, n0 = 32 * nb;
#pragma unroll 8
    for (int i = 0; i < 32; ++i) { const int kk = 2 * i + (lane >> 5); scr[kk * 33 + (lane & 31)] = W[(size_t)(k0 + kk) * ldw + col0 + n0 + (lane & 31)]; }
    asm volatile("s_waitcnt lgkmcnt(0)" ::: "memory");
    const int c = lane & 7;
#pragma unroll
    for (int j = 0; j < 4; ++j) { const int n = (lane >> 3) + 8 * j; const LAS float* s = scr + (8 * c) * 33 + n;
        u32x4 o; o.x = cvtpk(s[0 * 33], s[1 * 33]); o.y = cvtpk(s[2 * 33], s[3 * 33]); o.z = cvtpk(s[4 * 33], s[5 * 33]); o.w = cvtpk(s[6 * 33], s[7 * 33]);
        const int nn = n0 + n; const int row = MODE == 0 ? row_off + nn : row_off + (nn & ~63) + 2 * (nn & 31) + ((nn >> 5) & 1);
        *(u32x4*)(WT + (size_t)row * K + k0 + 8 * c) = o; }
    asm volatile("s_waitcnt lgkmcnt(0)" ::: "memory");
}

__device__ __forceinline__ void ln_phase(const float* R, float* out, bf16_t* outb, const float* g, const float* b, int gw, int NGW, int lane) {
    f32x4 gv[8], bv[8];
#pragma unroll
    for (int j = 0; j < 8; ++j) { gv[j] = *((const f32x4*)g + lane + 64 * j); bv[j] = *((const f32x4*)b + lane + 64 * j); }
    for (int row = gw; row < MTOK; row += NGW) {
        const f32x4* xr = (const f32x4*)(R + (size_t)row * DM) + lane;
        f32x4 v[8]; float s = 0.f;
#pragma unroll
        for (int j = 0; j < 8; ++j) { v[j] = xr[64 * j]; s += (v[j].x + v[j].y) + (v[j].z + v[j].w); }
        const float mean = wave_sum(s) * (1.f / DM); float s2 = 0.f;
#pragma unroll
        for (int j = 0; j < 8; ++j) { v[j] = v[j] - mean; s2 += (v[j].x * v[j].x + v[j].y * v[j].y) + (v[j].z * v[j].z + v[j].w * v[j].w); }
        const float rstd = 1.f / sqrtf(wave_sum(s2) * (1.f / DM) + LN_EPS);
        f32x4* o4 = (f32x4*)(out + (size_t)row * DM) + lane;
#pragma unroll
        for (int j = 0; j < 8; ++j) { const f32x4 y = v[j] * rstd * gv[j] + bv[j]; o4[64 * j] = y;
            if (outb) { u32x2 w; w.x = cvtpk(y.x, y.y); w.y = cvtpk(y.z, y.w); *((u32x2*)(outb + (size_t)row * DM) + lane + 64 * j) = w; } }
    }
}

constexpr int KS_STRIDE = 144, VT_STRIDE = 520, VT_OFF = 256 * KS_STRIDE;
__device__ __forceinline__ void attn_phase(LAS unsigned char* lds, const bf16_t* QZKV, const float* sinks, bf16_t* OG, int G, int bid) {
    const int tid = threadIdx.x, lane = tid & 63, wid = __builtin_amdgcn_readfirstlane(tid >> 6), r32 = lane & 31, hi = lane >> 5;
    LAS unsigned char* Ks = lds; LAS unsigned char* Vt = lds + VT_OFF;
    for (int u = bid; u < 512; u += G) {
        const int kvh = u & 3, nb = (u >> 2) & 31, b = u >> 7;
        const size_t tok0 = (size_t)b * SEQ + (size_t)nb * 128;
#pragma unroll
        for (int r = 0; r < 4; ++r) { const int id = tid + 512 * r, key = id >> 3, ch = id & 7;
            u32x4 kv = {0u, 0u, 0u, 0u};
            if (nb > 0 || key >= 128) kv = *(const u32x4*)(QZKV + (tok0 - 128 + key) * NQZKV + 4096 + kvh * 64 + ch * 8);
            *(LAS u32x4*)(Ks + key * KS_STRIDE + ch * 16) = kv; }
#pragma unroll
        for (int r = 0; r < 2; ++r) { const int id = tid + 512 * r, kp = id >> 3, ch = id & 7, key = 2 * kp;
            u32x4 v0 = {0u, 0u, 0u, 0u}, v1 = {0u, 0u, 0u, 0u};
            if (nb > 0 || key >= 128) { const bf16_t* p = QZKV + (tok0 - 128 + key) * NQZKV + 4352 + kvh * 64 + ch * 8; v0 = *(const u32x4*)p; v1 = *(const u32x4*)(p + NQZKV); }
#pragma unroll
            for (int i = 0; i < 4; ++i) { const unsigned a = v0[i], c = v1[i];
                *(LAS unsigned*)(Vt + (ch * 8 + 2 * i) * VT_STRIDE + key * 2) = (a & 0xffffu) | (c << 16);
                *(LAS unsigned*)(Vt + (ch * 8 + 2 * i + 1) * VT_STRIDE + key * 2) = (a >> 16) | (c & 0xffff0000u); } }
        __syncthreads();
        const int h = kvh * 8 + wid;
        const float sink2 = sinks[h] * LOG2E;
#pragma unroll 1
        for (int j = 0; j < 4; ++j) {
            const size_t token = tok0 + 32 * j + r32;
            const bf16_t* qrow = QZKV + token * NQZKV + h * 64;
            bf16x8 qf[4];
#pragma unroll
            for (int ks = 0; ks < 4; ++ks) qf[ks] = *(const bf16x8*)(qrow + 16 * ks + 8 * hi);
            f32x16 S[5];
#pragma unroll
            for (int tt = 0; tt < 5; ++tt) {
#pragma unroll
                for (int i = 0; i < 16; ++i) S[tt][i] = 0.f;
#pragma unroll
                for (int ks = 0; ks < 4; ++ks) { const bf16x8 kf = *(const LAS bf16x8*)(Ks + (32 * (j + tt) + r32) * KS_STRIDE + (16 * ks + 8 * hi) * 2);
                    S[tt] = __builtin_amdgcn_mfma_f32_32x32x16_bf16(kf, qf[ks], S[tt], 0, 0, 0); }
            }
            const float NEG = -INFINITY;
#pragma unroll
            for (int i = 0; i < 16; ++i) { const int cr = (i & 3) + 8 * (i >> 2) + 4 * hi;
                if (!(cr > r32)) S[0][i] = NEG;
                if (!(cr <= r32)) S[4][i] = NEG; }
            if (nb == 0) {
#pragma unroll
                for (int tt = 0; tt < 4; ++tt) if (j + tt < 4) {
#pragma unroll
                    for (int i = 0; i < 16; ++i) S[tt][i] = NEG; }
            }
            float mx = sink2;
#pragma unroll
            for (int tt = 0; tt < 5; ++tt)
#pragma unroll
                for (int i = 0; i < 16; ++i) mx = fmaxf(mx, S[tt][i]);
            mx = fmaxf(mx, __shfl_xor(mx, 32));
            float sum = 0.f;
#pragma unroll
            for (int tt = 0; tt < 5; ++tt)
#pragma unroll
                for (int i = 0; i < 16; ++i) { const float p = __builtin_amdgcn_exp2f(S[tt][i] - mx); S[tt][i] = p; sum += p; }
            sum += __shfl_xor(sum, 32);
            const float inv = 1.0f / (sum + __builtin_amdgcn_exp2f(sink2 - mx));
            f32x16 O[2];
#pragma unroll
            for (int dt = 0; dt < 2; ++dt)
#pragma unroll
                for (int i = 0; i < 16; ++i) O[dt][i] = 0.f;
#pragma unroll
            for (int tt = 0; tt < 5; ++tt)
#pragma unroll
                for (int s = 0; s < 2; ++s) {
                    u32x4 pw; pw.x = cvtpk(S[tt][8 * s + 0], S[tt][8 * s + 1]); pw.y = cvtpk(S[tt][8 * s + 2], S[tt][8 * s + 3]);
                    pw.z = cvtpk(S[tt][8 * s + 4], S[tt][8 * s + 5]); pw.w = cvtpk(S[tt][8 * s + 6], S[tt][8 * s + 7]);
                    const bf16x8 pf = __builtin_bit_cast(bf16x8, pw);
#pragma unroll
                    for (int dt = 0; dt < 2; ++dt) {
                        const LAS unsigned char* vp = Vt + (32 * dt + r32) * VT_STRIDE + (32 * (j + tt) + 16 * s + 4 * hi) * 2;
                        const s16x4 lo = *(const LAS s16x4*)vp, hi4 = *(const LAS s16x4*)(vp + 16);
                        const bf16x8 vf = __builtin_shufflevector(lo, hi4, 0, 1, 2, 3, 4, 5, 6, 7);
                        O[dt] = __builtin_amdgcn_mfma_f32_32x32x16_bf16(vf, pf, O[dt], 0, 0, 0);
                    }
                }
            const bf16_t* zrow = QZKV + token * NQZKV + 2048 + h * 64;
            bf16_t* orow = OG + token * DM + h * 64;
#pragma unroll
            for (int dt = 0; dt < 2; ++dt)
#pragma unroll
                for (int gq = 0; gq < 4; ++gq) { const int d0 = 32 * dt + 8 * gq + 4 * hi;
                    const u32x2 zw = *(const u32x2*)(zrow + d0);
                    const float o0 = O[dt][4 * gq + 0] * inv * silu_f(bf_lo(zw.x)), o1 = O[dt][4 * gq + 1] * inv * silu_f(bf_hi(zw.x));
                    const float o2 = O[dt][4 * gq + 2] * inv * silu_f(bf_lo(zw.y)), o3 = O[dt][4 * gq + 3] * inv * silu_f(bf_hi(zw.y));
                    u32x2 w; w.x = cvtpk(o0, o1); w.y = cvtpk(o2, o3); *(u32x2*)(orow + d0) = w; }
        }
        __syncthreads();
    }
}

__global__ void __launch_bounds__(NTHREADS, 2) yoco_fwd(Args a) {
    extern __shared__ __attribute__((aligned(16))) unsigned char lds_raw[];
    LAS unsigned char* lds = (LAS unsigned char*)lds_raw;
    cg::grid_group grid = cg::this_grid();
    const int tid = threadIdx.x, lane = tid & 63, wave = __builtin_amdgcn_readfirstlane(tid >> 6);
    const int G = gridDim.x, bid = blockIdx.x;
    const int gw = bid * NWAVES + wave, NGW = G * NWAVES;
    const int gt = bid * NTHREADS + tid, NGT = G * NTHREADS;
    unsigned char* ws = a.ws;
    bf16_t* XB = (bf16_t*)(ws + WS_XB); bf16_t* W1T = (bf16_t*)(ws + WS_W1T); bf16_t* WINU = (bf16_t*)(ws + WS_WINU); bf16_t* WGT = (bf16_t*)(ws + WS_WGT);
    bf16_t* W2T = (bf16_t*)(ws + WS_W2T); bf16_t* W3T = (bf16_t*)(ws + WS_W3T); bf16_t* W4T = (bf16_t*)(ws + WS_W4T);
    float* ROPE = (float*)(ws + WS_ROPE); bf16_t* HB = (bf16_t*)(ws + WS_H); bf16_t* YB = (bf16_t*)(ws + WS_Y); float* RB = (float*)(ws + WS_R);

    {
        for (int i = gt; i < MTOK * DM / 8; i += NGT) { const f32x4 v0 = *((const f32x4*)a.x + 2 * (size_t)i), v1 = *((const f32x4*)a.x + 2 * (size_t)i + 1);
            u32x4 w; w.x = cvtpk(v0.x, v0.y); w.y = cvtpk(v0.z, v0.w); w.z = cvtpk(v1.x, v1.y); w.w = cvtpk(v1.z, v1.w); *((u32x4*)XB + i) = w; }
        for (int i = gt; i < DM * DM / 8; i += NGT) { const int r = i >> 8, c8 = i & 255; const f32x4* p = (const f32x4*)(a.a_w_in + (size_t)r * NH1 + c8 * 8);
            const f32x4 v0 = p[0], v1 = p[1]; u32x4 w; w.x = cvtpk(v0.x, v0.y); w.y = cvtpk(v0.z, v0.w); w.z = cvtpk(v1.x, v1.y); w.w = cvtpk(v1.z, v1.w); *((u32x4*)WINU + i) = w; }
        for (int i = gt; i < SEQ * 32; i += NGT) { const int pos = i >> 5, fi = i & 31; const float ang = (float)pos * INV_FREQ[fi];
            const double rev = (double)ang * 0.15915494309189535; const float fr = (float)(rev - __builtin_rint(rev));
            f32x2 cs; cs.x = __builtin_amdgcn_cosf(fr); cs.y = __builtin_amdgcn_sinf(fr); *((f32x2*)ROPE + i) = cs; }
        LAS float* scr = (LAS float*)(lds + wave * 8448);
        constexpr int I_BIG = 32 * 64, I_G = 8 * 16, I_KV = 32 * 8;
        constexpr int NITEMS = 5 * I_BIG + 4 * I_G + 2 * I_KV;
        for (int it = gw; it < NITEMS; it += NGW) {
            int r = it;
            if (r < I_BIG) { transpose_item<0>(a.a_w_in, NH1, 2048, DM, 2048, W1T, 2048, scr, r, lane); continue; } r -= I_BIG;
            if (r < I_BIG) { transpose_item<0>(a.a_w_out, DM, 0, DM, DM, W2T, 0, scr, r, lane); continue; } r -= I_BIG;
            if (r < I_BIG) { transpose_item<1>(a.b_w_qg, NH1, 0, DM, 2048, W3T, 0, scr, r, lane); continue; } r -= I_BIG;
            if (r < I_BIG) { transpose_item<0>(a.b_w_qg, NH1, 2048, DM, 2048, W3T, 2048, scr, r, lane); continue; } r -= I_BIG;
            if (r < I_BIG) { transpose_item<0>(a.b_w_out, DM, 0, DM, DM, W4T, 0, scr, r, lane); continue; } r -= I_BIG;
            if (r < 4 * I_G) { const int g = r / I_G; transpose_item<0>(a.a_w_group + (size_t)g * 512 * 512, 512, 0, 512, 512, WGT, g * 512, scr, r % I_G, lane); continue; } r -= 4 * I_G;
            if (r < I_KV) { transpose_item<1>(a.b_w_k, 256, 0, DM, 256, W3T, 4096, scr, r, lane); continue; } r -= I_KV;
            transpose_item<0>(a.b_w_v, 256, 0, DM, 256, W3T, 4352, scr, r, lane);
        }
    }
    grid.sync();
    {
        pg8::Gemm g{WGT, WINU, 2048, 2048, 512, 512, 2048, 1, 512 * 2}; pg8::StaticOrder S; S.init(2048, 2048, G, bid);
        pg8::EpiBf16 E{W1T, DM};
        pg8::gemm_phase<pg8::EpiBf16, pg8::StaticOrder, true>(lds, g, S, E);
    }
    grid.sync();
    {
        pg8::Gemm g{XB, W1T, MTOK, NH1, DM, DM, DM, 0, 0}; pg8::StaticOrder S; S.init(MTOK, NH1, G, bid);
        pg8::EpiBf16 E{HB, NH1};
        pg8::gemm_phase<pg8::EpiBf16, pg8::StaticOrder, true>(lds, g, S, E);
    }
    grid.sync();
    {
        for (int it = gw; it < 2048; it += NGW) {
            const int g = it & 3, rc = it >> 2, w = 2 << g, t0 = rc * 32, p0 = t0 & (SEQ - 1), col = g * 512 + lane * 8;
            const f32x4 sc0 = *(const f32x4*)(a.a_scale + col), sc1 = *(const f32x4*)(a.a_scale + col + 4);
            float sum[8];
#pragma unroll
            for (int i = 0; i < 8; ++i) sum[i] = 0.f;
            for (int k = 1; k <= w; ++k) if (p0 - k >= 0) { const u32x4 uw = *(const u32x4*)(HB + (size_t)(t0 - k) * NH1 + col);
#pragma unroll
                for (int i = 0; i < 4; ++i) { sum[2 * i] += bf_lo(uw[i]); sum[2 * i + 1] += bf_hi(uw[i]); } }
#pragma unroll 4
            for (int r = 0; r < 32; ++r) { const int t = t0 + r, pos = p0 + r;
                const u32x4 uw = *(const u32x4*)(HB + (size_t)t * NH1 + col); const u32x4 zw = *(const u32x4*)(HB + (size_t)t * NH1 + 2048 + col);
                u32x4 ow = {0u, 0u, 0u, 0u}; if (pos >= w) ow = *(const u32x4*)(HB + (size_t)(t - w) * NH1 + col);
                const int cnt = pos + 1 < w ? pos + 1 : w; const float rc_ = 1.0f / (float)cnt;
                float y[8];
#pragma unroll
                for (int i = 0; i < 4; ++i) { const float u0 = bf_lo(uw[i]), u1 = bf_hi(uw[i]);
                    sum[2 * i] += u0 - bf_lo(ow[i]); sum[2 * i + 1] += u1 - bf_hi(ow[i]);
                    const float s0 = i < 2 ? sc0[2 * i] : sc1[2 * i - 4], s1 = i < 2 ? sc0[2 * i + 1] : sc1[2 * i - 3];
                    y[2 * i] = (sum[2 * i] * rc_ - u0) * s0 * silu_f(bf_lo(zw[i])); y[2 * i + 1] = (sum[2 * i + 1] * rc_ - u1) * s1 * silu_f(bf_hi(zw[i])); }
                u32x4 o; o.x = cvtpk(y[0], y[1]); o.y = cvtpk(y[2], y[3]); o.z = cvtpk(y[4], y[5]); o.w = cvtpk(y[6], y[7]);
                *(u32x4*)(YB + (size_t)t * DM + col) = o; }
        }
    }
    grid.sync();
    {
        pg8::Gemm g{YB, W2T, MTOK, DM, DM, DM, DM, 0, 0}; pg8::StaticOrder S; S.init(MTOK, DM, G, bid);
        pg8::EpiRes E{a.x, RB, DM};
        pg8::gemm_phase<pg8::EpiRes, pg8::StaticOrder, true>(lds, g, S, E);
    }
    grid.sync();
    ln_phase(RB, RB, XB, a.ln_g, a.ln_b, gw, NGW, lane);
    grid.sync();
    {
        pg8::Gemm g{XB, W3T, MTOK, NQZKV, DM, DM, DM, 0, 0}; pg8::StaticOrder S; S.init(MTOK, NQZKV, G, bid);
        pg8::EpiQKV E{HB, ROPE};
        pg8::gemm_phase<pg8::EpiQKV, pg8::StaticOrder, true>(lds, g, S, E);
    }
    grid.sync();
    attn_phase(lds, HB, a.b_sinks, YB, G, bid);
    grid.sync();
    {
        pg8::Gemm g{YB, W4T, MTOK, DM, DM, DM, DM, 0, 0}; pg8::StaticOrder S; S.init(MTOK, DM, G, bid);
        pg8::EpiRes E{RB, a.out, DM};
        pg8::gemm_phase<pg8::EpiRes, pg8::StaticOrder, true>(lds, g, S, E);
    }
    grid.sync();
    ln_phase(a.out, a.out, nullptr, a.ln_g + DM, a.ln_b + DM, gw, NGW, lane);
}

extern "C" void kernel_launch(void* const* d_in, const int* in_sizes, int n_in, void* d_out, int out_size, void* d_ws, size_t ws_size, hipStream_t stream) {
    static int grid = 0;
    if (grid == 0) {
        if (n_in != 12 || out_size != MTOK * DM || ws_size < WS_END) { fprintf(stderr, "kernel_launch: unexpected shapes (n_in %d out %d ws %zu)\n", n_in, out_size, ws_size); grid = -1; return; }
        int dev = 0, cus = 0, per_cu = 0;
        hipGetDevice(&dev); hipDeviceGetAttribute(&cus, hipDeviceAttributeMultiprocessorCount, dev);
        if (hipFuncSetAttribute((const void*)yoco_fwd, hipFuncAttributeMaxDynamicSharedMemorySize, LDS_BYTES) != hipSuccess) { fprintf(stderr, "kernel_launch: hipFuncSetAttribute failed\n"); grid = -1; return; }
        if (hipOccupancyMaxActiveBlocksPerMultiprocessor(&per_cu, (const void*)yoco_fwd, NTHREADS, LDS_BYTES) != hipSuccess || per_cu < 1) { fprintf(stderr, "kernel_launch: occupancy query gives %d\n", per_cu); (void)hipGetLastError(); grid = -1; return; }
        grid = cus;
    }
    if (grid < 0) return;
    Args a{};
    a.x = (const float*)d_in[0]; a.ln_g = (const float*)d_in[1]; a.ln_b = (const float*)d_in[2]; a.a_w_in = (const float*)d_in[3]; a.a_w_group = (const float*)d_in[4];
    a.a_scale = (const float*)d_in[5]; a.a_w_out = (const float*)d_in[6]; a.b_w_k = (const float*)d_in[7]; a.b_w_v = (const float*)d_in[8]; a.b_w_qg = (const float*)d_in[9];
    a.b_sinks = (const float*)d_in[10]; a.b_w_out = (const float*)d_in[11]; a.out = (float*)d_out; a.ws = (unsigned char*)d_ws;
    void* args[] = {&a};
    hipError_t e = hipLaunchCooperativeKernel((const void*)yoco_fwd, dim3(grid), dim3(NTHREADS), args, LDS_BYTES, stream);
    if (e != hipSuccess) fprintf(stderr, "kernel_launch: cooperative launch failed: %s (grid %d)\n", hipGetErrorString(e), grid);
}
```
